# Optimizing an MI355X kernel written in HIP

```python
import math
import jax, jax.numpy as jnp
from jax import lax
import numpy as np

D_MODEL = 1024
BATCH = 2
SEQ = 8192
DEPTH = 1

D_RNN = 1024
RNN_BLOCKS = 16
RNN_BW = D_RNN // RNN_BLOCKS
CONV_W = 4
LRU_C = 8.0
N_HEADS = 16
N_KV = 4
HEAD_DIM = 64
GROUP = N_HEADS // N_KV
WINDOW = 128
BLOCK_Q = 128
Q_DIM = N_HEADS * HEAD_DIM
KV_DIM = N_KV * HEAD_DIM
N_EXPERTS = 32
TOP_K = 4
D_FF = 1024
SWIGLU_LIMIT = 7.0
SWIGLU_ALPHA = 1.702
MOE_BLOCK = 128
EPS = 1e-6
SPLITS = (D_RNN, D_RNN, Q_DIM, KV_DIM, KV_DIM, D_MODEL, D_MODEL)
D_IN = sum(SPLITS)

kernel_name = "hybrid_rglru_swa_sink_moe_block"


def rmsnorm(x, g):
    xf = x.astype(jnp.float32)
    y = xf * lax.rsqrt(jnp.mean(xf * xf, axis=-1, keepdims=True) + EPS)
    return (y * g.astype(jnp.float32)).astype(x.dtype)


def causal_depthwise_conv(x, w, b):
    S = x.shape[1]
    xp = jnp.pad(x, ((0, 0), (CONV_W - 1, 0), (0, 0)))
    y = b
    for kk in range(CONV_W):
        y = y + xp[:, kk:kk + S] * w[kk]
    return y


def rg_lru(x, w_a, b_a, w_x, b_x, lam):
    B, S, _ = x.shape
    xb = x.reshape(B, S, RNN_BLOCKS, RNN_BW)
    gate_r = jax.nn.sigmoid(jnp.einsum('bshi,hij->bshj', xb, w_a).reshape(B, S, D_RNN) + b_a)
    gate_i = jax.nn.sigmoid(jnp.einsum('bshi,hij->bshj', xb, w_x).reshape(B, S, D_RNN) + b_x)
    log_a = -LRU_C * gate_r.astype(jnp.float32) * jax.nn.softplus(-lam.astype(jnp.float32))
    a = jnp.exp(log_a)
    mult = jnp.sqrt(-jnp.expm1(2.0 * log_a))
    reset = (jnp.arange(S) == 0)[None, :, None]
    mult = jnp.where(reset, 1.0, mult)
    bterm = (x * gate_i).astype(jnp.float32) * mult

    def combine(left, right):
        a1, b1 = left
        a2, b2 = right
        return a1 * a2, a2 * b1 + b2

    _, h = lax.associative_scan(combine, (a, bterm), axis=1)
    return h.astype(x.dtype)


def alibi_slopes():
    return np.array([2.0 ** (-8.0 * (h + 1) / N_HEADS) for h in range(N_HEADS)], dtype=np.float32)


def swa_sink_attention(q, k, v, sinks):
    B, S = q.shape[0], q.shape[1]
    nb = S // BLOCK_Q
    qb = q.reshape(B, nb, BLOCK_Q, N_KV, GROUP, HEAD_DIM)
    pad = ((0, 0), (BLOCK_Q, 0), (0, 0), (0, 0))
    kb = jnp.pad(k, pad).reshape(B, nb + 1, BLOCK_Q, N_KV, HEAD_DIM)
    vb = jnp.pad(v, pad).reshape(B, nb + 1, BLOCK_Q, N_KV, HEAD_DIM)
    k_band = jnp.concatenate([kb[:, :-1], kb[:, 1:]], axis=2)
    v_band = jnp.concatenate([vb[:, :-1], vb[:, 1:]], axis=2)
    s = jnp.einsum('bnqkgd,bnckd->bnkgqc', qb, k_band,
                   preferred_element_type=jnp.float32) * (HEAD_DIM ** -0.5)
    qi = jnp.arange(BLOCK_Q)[:, None]
    ci = jnp.arange(2 * BLOCK_Q)[None, :]
    dist = qi + BLOCK_Q - ci
    kpos = jnp.arange(nb)[:, None, None] * BLOCK_Q - BLOCK_Q + ci[None]
    valid = (dist >= 0) & (dist < WINDOW) & (kpos >= 0)
    slopes = jnp.asarray(alibi_slopes()).reshape(N_KV, GROUP)[:, :, None, None]
    s = s - slopes * dist.astype(jnp.float32)
    s = jnp.where(valid[None, :, None, None], s, -jnp.inf)
    sink = sinks.astype(jnp.float32).reshape(N_KV, GROUP)[:, :, None, None]
    m = jnp.maximum(jnp.max(s, axis=-1, keepdims=True), sink)
    p = jnp.exp(s - m)
    denom = jnp.sum(p, axis=-1, keepdims=True) + jnp.exp(sink - m)
    o = jnp.einsum('bnkgqc,bnckd->bnqkgd', (p / denom).astype(v.dtype), v_band)
    return o.reshape(B, S, Q_DIM)


def clamped_swiglu(hid):
    x_glu = jnp.minimum(hid[..., ::2], SWIGLU_LIMIT)
    x_lin = jnp.clip(hid[..., 1::2], -SWIGLU_LIMIT, SWIGLU_LIMIT)
    return x_glu * jax.nn.sigmoid(SWIGLU_ALPHA * x_glu) * (x_lin + 1.0)


def moe_ffn(h, router_w, router_b, w1, b1, w2, b2):
    B, S, D = h.shape
    N = B * S
    xt = h.reshape(N, D)
    logits = (xt @ router_w + router_b).astype(jnp.float32)
    top_v, top_e = lax.top_k(logits, TOP_K)
    gates = jax.nn.softmax(top_v, axis=-1)
    A = N * TOP_K
    e_flat = top_e.reshape(A)
    g_flat = gates.reshape(A)
    tok = jnp.arange(A, dtype=jnp.int32) // TOP_K
    order = jnp.argsort(e_flat, stable=True)
    e_s, tok_s, g_s = e_flat[order], tok[order], g_flat[order]
    counts = jnp.bincount(e_flat, length=N_EXPERTS)
    starts = jnp.cumsum(counts) - counts
    padded = ((counts + MOE_BLOCK - 1) // MOE_BLOCK) * MOE_BLOCK
    pend = jnp.cumsum(padded)
    pstart = pend - padded
    dest = pstart[e_s] + jnp.arange(A, dtype=jnp.int32) - starts[e_s]
    P = A + N_EXPERTS * MOE_BLOCK
    nblk = P // MOE_BLOCK
    tok_buf = jnp.full((P,), N, dtype=jnp.int32).at[dest].set(tok_s)
    g_buf = jnp.zeros((P,), jnp.float32).at[dest].set(g_s)
    blk_e = jnp.clip(jnp.searchsorted(pend, jnp.arange(nblk, dtype=jnp.int32) * MOE_BLOCK,
                                      side='right'), 0, N_EXPERTS - 1)
    x_pad = jnp.concatenate([xt, jnp.zeros((1, D), xt.dtype)], axis=0)
    xb = x_pad[tok_buf].reshape(nblk, MOE_BLOCK, D)

    def expert_block(args):
        xblk, e = args
        act = clamped_swiglu(xblk @ w1[e] + b1[e])
        return act @ w2[e] + b2[e]

    yb = lax.map(expert_block, (xb, blk_e)).reshape(P, D)
    yb = yb * g_buf[:, None].astype(yb.dtype)
    out = jax.ops.segment_sum(yb, tok_buf, num_segments=N + 1)[:N]
    return out.reshape(B, S, D)


def setup_inputs(seed: int = 0) -> dict:
    key = jax.random.key(seed)
    ks = jax.random.split(key, 24)
    f32 = jnp.float32
    L = DEPTH

    def nrm(k, shape, scale):
        return jax.random.normal(k, shape, f32) * scale

    def gain(k, shape):
        return 1.0 + 0.05 * jax.random.normal(k, shape, f32)

    u = jax.random.uniform(ks[12], (L, D_RNN), f32, 0.9, 0.999)
    sig = u ** (1.0 / LRU_C)
    rg_lambda = jnp.log(sig) - jnp.log1p(-sig)
    return {
        "x": nrm(ks[0], (BATCH, SEQ, D_MODEL), 1.0),
        "c": nrm(ks[1], (BATCH, D_MODEL), 1.0),
        "w_ada": nrm(ks[2], (L, D_MODEL, 6 * D_MODEL), 0.5 * D_MODEL ** -0.5),
        "b_ada": nrm(ks[3], (L, 6 * D_MODEL), 0.02),
        "norm_pre_mix": gain(ks[4], (L, D_MODEL)),
        "norm_post_mix": gain(ks[5], (L, D_MODEL)),
        "norm_pre_ffn": gain(ks[6], (L, D_MODEL)),
        "norm_post_ffn": gain(ks[7], (L, D_MODEL)),
        "w_in": nrm(ks[8], (L, D_MODEL, D_IN), D_MODEL ** -0.5),
        "b_in": nrm(ks[9], (L, D_IN), 0.02),
        "conv_w": nrm(ks[10], (L, CONV_W, D_RNN), CONV_W ** -0.5),
        "conv_b": nrm(ks[11], (L, D_RNN), 0.02),
        "rg_w_a": nrm(ks[13], (L, RNN_BLOCKS, RNN_BW, RNN_BW), RNN_BW ** -0.5),
        "rg_b_a": nrm(ks[14], (L, D_RNN), 0.02),
        "rg_w_x": nrm(ks[15], (L, RNN_BLOCKS, RNN_BW, RNN_BW), RNN_BW ** -0.5),
        "rg_b_x": nrm(ks[16], (L, D_RNN), 0.02),
        "rg_lambda": rg_lambda,
        "attn_sinks": nrm(ks[17], (L, N_HEADS), 0.5),
        "w_o_rnn": nrm(ks[18], (L, D_RNN, D_MODEL), D_RNN ** -0.5),
        "w_o_attn": nrm(ks[19], (L, Q_DIM, D_MODEL), Q_DIM ** -0.5),
        "w_out": nrm(ks[20], (L, D_MODEL, D_MODEL), D_MODEL ** -0.5),
        "router_w": nrm(ks[21], (L, D_MODEL, N_EXPERTS), D_MODEL ** -0.5),
        "router_b": nrm(ks[22], (L, N_EXPERTS), 0.01),
        "moe_w1": nrm(jax.random.fold_in(ks[23], 0), (L, N_EXPERTS, D_MODEL, 2 * D_FF), D_MODEL ** -0.5),
        "moe_b1": nrm(jax.random.fold_in(ks[23], 1), (L, N_EXPERTS, 2 * D_FF), 0.02),
        "moe_w2": nrm(jax.random.fold_in(ks[23], 2), (L, N_EXPERTS, D_FF, D_MODEL), D_FF ** -0.5),
        "moe_b2": nrm(jax.random.fold_in(ks[23], 3), (L, N_EXPERTS, D_MODEL), 0.02),
    }


def reference(x, c, w_ada, b_ada, norm_pre_mix, norm_post_mix, norm_pre_ffn, norm_post_ffn,
              w_in, b_in, conv_w, conv_b, rg_w_a, rg_b_a, rg_w_x, rg_b_x, rg_lambda,
              attn_sinks, w_o_rnn, w_o_attn, w_out, router_w, router_b,
              moe_w1, moe_b1, moe_w2, moe_b2):
    B, S, _ = x.shape
    split_points = np.cumsum(np.array(SPLITS))[:-1].tolist()
    for layer in range(DEPTH):
        ada = (jax.nn.silu(c) @ w_ada[layer] + b_ada[layer])[:, None, :]
        sh1, sc1, g1, sh2, sc2, g2 = jnp.split(ada, 6, axis=-1)

        h = rmsnorm(x, norm_pre_mix[layer]) * (1.0 + sc1) + sh1
        proj = h @ w_in[layer] + b_in[layer]
        xr, gr, q, k, v, gate_r, gate_a = jnp.split(proj, split_points, axis=-1)
        xr = causal_depthwise_conv(xr, conv_w[layer], conv_b[layer])
        y_rnn = rg_lru(xr, rg_w_a[layer], rg_b_a[layer], rg_w_x[layer], rg_b_x[layer],
                       rg_lambda[layer]) * jax.nn.gelu(gr)
        y_att = swa_sink_attention(q.reshape(B, S, N_HEADS, HEAD_DIM),
                                   k.reshape(B, S, N_KV, HEAD_DIM),
                                   v.reshape(B, S, N_KV, HEAD_DIM), attn_sinks[layer])
        merged = (jax.nn.sigmoid(gate_r) * (y_rnn @ w_o_rnn[layer])
                  + jax.nn.sigmoid(gate_a) * (y_att @ w_o_attn[layer]))
        mix = merged @ w_out[layer]
        x = x + g1 * rmsnorm(mix, norm_post_mix[layer])

        h = rmsnorm(x, norm_pre_ffn[layer]) * (1.0 + sc2) + sh2
        ff = moe_ffn(h, router_w[layer], router_b[layer], moe_w1[layer], moe_b1[layer],
                     moe_w2[layer], moe_b2[layer])
        x = x + g2 * rmsnorm(ff, norm_post_ffn[layer])
    return x
```

```cpp
#include <hip/hip_runtime.h>
#include <cstdio>
#include <cstdint>

constexpr int BATCH = 2, SEQ = 8192, DM = 1024, NTOK = BATCH * SEQ;
constexpr int NBLK = 16, BW = 64, CONVW = 4;
constexpr int NH = 16, NKV = 4, HD = 64, GROUP = 4, WINDOW = 128;
constexpr int KVDIM = 256;
constexpr int NE = 32, TOPK = 4, DFF = 1024;
constexpr int DIN = 5632;
constexpr int NASSIGN = NTOK * TOPK;
constexpr float EPS = 1e-6f;
constexpr int C_XR = 0, C_GR = 1024, C_Q = 2048, C_K = 3072, C_V = 3328, C_GTR = 3584, C_GTA = 4608;

constexpr size_t MiB = 1u << 20;
constexpr size_t OFF_ADA = 0, OFF_CNT = 64 * 1024, OFF_GATES = 128 * 1024, OFF_EIDX = 512 * 1024, OFF_LIST = 1 * MiB;
constexpr size_t WS_XR = 4 * MiB, WS_GR = 68 * MiB, WS_Q = 132 * MiB, WS_K = 196 * MiB, WS_V = 212 * MiB, WS_GTR = 228 * MiB, WS_GTA = 292 * MiB;
constexpr size_t WS_H = 356 * MiB;
constexpr size_t WS_YATT = 420 * MiB;
constexpr size_t WS_T1 = 4 * MiB, WS_T2 = 68 * MiB, WS_MERGED = 132 * MiB;
constexpr size_t WS_MIX = 4 * MiB, WS_X1 = 68 * MiB, WS_H2 = 132 * MiB, WS_ACT = 196 * MiB  , WS_FF = 4 * MiB;
constexpr size_t WS_NEED = 484 * MiB;

__device__ __forceinline__ float sigmoidf_(float x) { return 1.f / (1.f + expf(-x)); }
__device__ __forceinline__ float wave_sum(float v) {
#pragma unroll
    for (int o = 32; o > 0; o >>= 1) v += __shfl_xor(v, o);
    return v;
}
__device__ __forceinline__ float wave_max(float v) {
#pragma unroll
    for (int o = 32; o > 0; o >>= 1) v = fmaxf(v, __shfl_xor(v, o));
    return v;
}

__global__ void k_ada(const float* c, const float* w_ada, const float* b_ada, float* ada) {
    const int idx = blockIdx.x * 256 + threadIdx.x; const int b = idx / 6144, j = idx % 6144;
    float s = 0.f;
    for (int k = 0; k < DM; ++k) { const float cv = c[b * DM + k]; s += cv * sigmoidf_(cv) * w_ada[(size_t)k * 6144 + j]; }
    ada[idx] = s + b_ada[j];
}
__global__ void k_rmsmod(const float* x, const float* gain, const float* ada, int sh_off, int sc_off, float* out) {
    const int row = blockIdx.x * 4 + (threadIdx.x >> 6), lane = threadIdx.x & 63; const int b = row / SEQ;
    const float* xr = x + (size_t)row * DM; float v[16]; float s = 0.f;
#pragma unroll
    for (int i = 0; i < 16; ++i) { v[i] = xr[lane + 64 * i]; s += v[i] * v[i]; }
    const float rstd = rsqrtf(wave_sum(s) * (1.f / DM) + EPS);
#pragma unroll
    for (int i = 0; i < 16; ++i) { const int cidx = lane + 64 * i;
        out[(size_t)row * DM + cidx] = v[i] * rstd * gain[cidx] * (1.f + ada[b * 6144 + sc_off + cidx]) + ada[b * 6144 + sh_off + cidx]; }
}
__global__ void k_resnorm(const float* base, const float* y, const float* gain, const float* ada, int g_off, float* out) {
    const int row = blockIdx.x * 4 + (threadIdx.x >> 6), lane = threadIdx.x & 63; const int b = row / SEQ;
    const float* yr = y + (size_t)row * DM; float v[16]; float s = 0.f;
#pragma unroll
    for (int i = 0; i < 16; ++i) { v[i] = yr[lane + 64 * i]; s += v[i] * v[i]; }
    const float rstd = rsqrtf(wave_sum(s) * (1.f / DM) + EPS);
#pragma unroll
    for (int i = 0; i < 16; ++i) { const int cidx = lane + 64 * i;
        out[(size_t)row * DM + cidx] = base[(size_t)row * DM + cidx] + ada[b * 6144 + g_off + cidx] * (v[i] * rstd * gain[cidx]); }
}

struct GemmArgs {
    const float* A; const int* rowlist; const int* counts; const float* B; size_t bstride;
    int lda, rowshift, liststride, ldb, M, N, K, pad;
};
static GemmArgs mk_gemm(const float* A, int lda, const int* rowlist, int rowshift, int liststride, const int* counts, const float* B, int ldb, size_t bstride, int M, int N, int K) {
    GemmArgs g; g.A = A; g.rowlist = rowlist; g.counts = counts; g.B = B; g.bstride = bstride; g.lda = lda; g.rowshift = rowshift; g.liststride = liststride; g.ldb = ldb; g.M = M; g.N = N; g.K = K; g.pad = 0; return g; }
struct EpiStore { float* C; const float* bias; int ldc; int pad;
    __device__ void operator()(int z, int m, int rid, int n, const float (&v)[4]) const {
#pragma unroll
        for (int j = 0; j < 4; ++j) C[(size_t)m * ldc + n + j] = v[j] + (bias ? bias[n + j] : 0.f); } };
struct EpiSwiglu { float* ACT; const float* b1;
    __device__ void operator()(int z, int m, int rid, int n, const float (&v)[4]) const {
#pragma unroll
        for (int p = 0; p < 2; ++p) { float g = v[2 * p] + b1[(size_t)z * 2 * DFF + n + 2 * p], l = v[2 * p + 1] + b1[(size_t)z * 2 * DFF + n + 2 * p + 1];
            g = fminf(g, 7.f); l = fminf(fmaxf(l, -7.f), 7.f);
            ACT[(size_t)rid * DFF + (n >> 1) + p] = g * sigmoidf_(1.702f * g) * (l + 1.f); } } };
struct EpiMoeOut { float* FF; const float* b2; const float* gates;
    __device__ void operator()(int z, int m, int rid, int n, const float (&v)[4]) const {
        const float g = gates[rid]; const int tok = rid >> 2;
#pragma unroll
        for (int j = 0; j < 4; ++j) atomicAdd(&FF[(size_t)tok * DM + n + j], g * (v[j] + b2[(size_t)z * DM + n + j])); } };

template <class Epi> __global__ __launch_bounds__(256) void k_gemm(GemmArgs g, Epi epi) {
    __shared__ float As[16][68]; __shared__ float Bs[16][68];
    const int z = blockIdx.z; const int M = g.counts ? g.counts[z] : g.M;
    const int m0 = blockIdx.y * 64, n0 = blockIdx.x * 64; if (m0 >= M) return;
    const int tid = threadIdx.x, ty = tid >> 4, tx = tid & 15;
    const float* Bz = g.B + (size_t)z * g.bstride;
    const int ar = tid >> 2, ak = (tid & 3) * 4; int arow = m0 + ar; const bool aval = arow < M;
    int asrc = 0; if (aval) asrc = g.rowlist ? (g.rowlist[(size_t)z * g.liststride + arow] >> g.rowshift) : arow;
    const float* Ap = g.A + (size_t)asrc * g.lda + ak;
    const int bk = tid >> 4, bn = (tid & 15) * 4;
    float acc[4][4] = {};
    for (int k0 = 0; k0 < g.K; k0 += 16) {
        float4 av = aval ? *(const float4*)(Ap + k0) : make_float4(0.f, 0.f, 0.f, 0.f);
        float4 bv = *(const float4*)(Bz + (size_t)(k0 + bk) * g.ldb + n0 + bn);
        __syncthreads();
        As[ak + 0][ar] = av.x; As[ak + 1][ar] = av.y; As[ak + 2][ar] = av.z; As[ak + 3][ar] = av.w;
        *(float4*)&Bs[bk][bn] = bv;
        __syncthreads();
#pragma unroll
        for (int k = 0; k < 16; ++k) { const float4 a = *(const float4*)&As[k][ty * 4]; const float4 b = *(const float4*)&Bs[k][tx * 4];
            const float aa[4] = {a.x, a.y, a.z, a.w}, bb[4] = {b.x, b.y, b.z, b.w};
#pragma unroll
            for (int i = 0; i < 4; ++i)
#pragma unroll
                for (int j = 0; j < 4; ++j) acc[i][j] += aa[i] * bb[j]; }
    }
#pragma unroll
    for (int i = 0; i < 4; ++i) { const int m = m0 + ty * 4 + i; if (m < M) { const int rid = g.rowlist ? g.rowlist[(size_t)z * g.liststride + m] : m; epi(z, m, rid, n0 + tx * 4, acc[i]); } }
}

__global__ void k_conv(const float* XR, const float* conv_w, const float* conv_b, float* XC) {
    const size_t idx = (size_t)blockIdx.x * 256 + threadIdx.x; const int c = idx % DM; const int row = idx / DM; const int t = row % SEQ;
    float y = conv_b[c];
#pragma unroll
    for (int k = 0; k < CONVW; ++k) { const int tt = t - (CONVW - 1) + k; if (tt >= 0) y += conv_w[k * DM + c] * XR[(size_t)(row - (CONVW - 1) + k) * DM + c]; }
    XC[idx] = y;
}
__global__ void k_gates(const float* XC, const float* w_a, const float* b_a, const float* w_x, const float* b_x, const float* lam, float* LOGA, float* BT) {
    const size_t idx = (size_t)blockIdx.x * 256 + threadIdx.x; const int c = idx % DM; const int row = idx / DM; const int t = row % SEQ;
    const int blk = c / BW, j = c % BW; const float* xb = XC + (size_t)row * DM + blk * BW;
    float sa = 0.f, sx = 0.f;
    for (int i = 0; i < BW; ++i) { const float xv = xb[i]; sa += xv * w_a[(blk * BW + i) * BW + j]; sx += xv * w_x[(blk * BW + i) * BW + j]; }
    const float gr = sigmoidf_(sa + b_a[c]), gi = sigmoidf_(sx + b_x[c]);
    const float l = lam[c]; const float sp = log1pf(expf(-l));
    const float log_a = -8.0f * gr * sp;
    float mult = sqrtf(-expm1f(2.f * log_a)); if (t == 0) mult = 1.f;
    LOGA[idx] = log_a;
    BT[idx] = XC[idx] * gi * mult;
}
__device__ __forceinline__ float gelu_tanh(float x) { return 0.5f * x * (1.f + tanhf(0.7978845608028654f * (x + 0.044715f * x * x * x))); }
__global__ void k_scan(const float* LOGA, const float* BT, const float* GR, float* YR) {
    const int idx = blockIdx.x * 64 + threadIdx.x; const int b = idx / DM, c = idx % DM;
    float h = 0.f;
    for (int t = 0; t < SEQ; ++t) { const size_t o = ((size_t)b * SEQ + t) * DM + c;
        const float a = expf(LOGA[o]); h = a * h + BT[o];
        YR[o] = h * gelu_tanh(GR[o]); }
}
__global__ __launch_bounds__(256) void k_attn(const float* Q, const float* K, const float* V, const float* sinks, float* YA) {
    __shared__ float ps[4][WINDOW]; __shared__ float qs[4][HD];
    const int w = threadIdx.x >> 6, lane = threadIdx.x & 63; const int task = blockIdx.x * 4 + w; const int row = task / NH, h = task % NH;
    const int t = row % SEQ; const int kvh = h / GROUP;
    qs[w][lane] = Q[(size_t)row * DM + h * HD + lane];
    __syncthreads();
    const float slope = exp2f(-0.5f * (float)(h + 1)); const float sink = sinks[h];
    float sc[2];
#pragma unroll
    for (int r = 0; r < 2; ++r) { const int j = lane + 64 * r; float s = -INFINITY;
        if (t - j >= 0) { const float* kp = K + (size_t)(row - j) * KVDIM + kvh * HD; float d = 0.f;
            for (int e = 0; e < HD; ++e) d += qs[w][e] * kp[e];
            s = d * 0.125f - slope * (float)j; }
        sc[r] = s; }
    const float m = fmaxf(wave_max(fmaxf(sc[0], sc[1])), sink);
    const float p0 = expf(sc[0] - m), p1 = expf(sc[1] - m);
    const float denom = wave_sum(p0 + p1) + expf(sink - m);
    ps[w][lane] = p0 / denom; ps[w][lane + 64] = p1 / denom;
    __syncthreads();
    float o = 0.f; const int jmax = t < WINDOW - 1 ? t : WINDOW - 1;
    for (int j = 0; j <= jmax; ++j) o += ps[w][j] * V[(size_t)(row - j) * KVDIM + kvh * HD + lane];
    YA[(size_t)row * DM + h * HD + lane] = o;
}
__global__ void k_merge(const float* GTR, const float* GTA, const float* T1, const float* T2, float* MG) {
    const size_t idx = (size_t)blockIdx.x * 256 + threadIdx.x;
    MG[idx] = sigmoidf_(GTR[idx]) * T1[idx] + sigmoidf_(GTA[idx]) * T2[idx];
}
__global__ void k_router(const float* H2, const float* rw, const float* rb, float* gates, int* eidx) {
    const int tok = blockIdx.x * 64 + threadIdx.x; float lg[NE];
#pragma unroll
    for (int e = 0; e < NE; ++e) lg[e] = rb[e];
    for (int k = 0; k < DM; ++k) { const float hv = H2[(size_t)tok * DM + k];
#pragma unroll
        for (int e = 0; e < NE; ++e) lg[e] += hv * rw[k * NE + e]; }
    float tv[TOPK]; int te[TOPK]; unsigned used = 0u;
#pragma unroll
    for (int s = 0; s < TOPK; ++s) { float best = -INFINITY; int bi = 0;
#pragma unroll
        for (int e = 0; e < NE; ++e) { const bool ok = !((used >> e) & 1u) && lg[e] > best; best = ok ? lg[e] : best; bi = ok ? e : bi; }
        used |= 1u << bi; tv[s] = best; te[s] = bi; }
    float den = 0.f; float ex[TOPK];
#pragma unroll
    for (int s = 0; s < TOPK; ++s) { ex[s] = expf(tv[s] - tv[0]); den += ex[s]; }
#pragma unroll
    for (int s = 0; s < TOPK; ++s) { gates[tok * TOPK + s] = ex[s] / den; eidx[tok * TOPK + s] = te[s]; }
}
__global__ void k_lists(const int* eidx, int* lists, int* counts) {
    const int e = threadIdx.x; if (e >= NE) return; int n = 0;
    for (int a = 0; a < NASSIGN; ++a) if (eidx[a] == e) lists[(size_t)e * NTOK + n++] = a;
    counts[e] = n;
}

extern "C" void kernel_launch(void* const* d_in, const int* in_sizes, int n_in, void* d_out, int out_size, void* d_ws, size_t ws_size, hipStream_t stream) {
    const float* x = (const float*)d_in[0]; const float* c = (const float*)d_in[1]; const float* w_ada = (const float*)d_in[2]; const float* b_ada = (const float*)d_in[3];
    const float* n_pre_mix = (const float*)d_in[4]; const float* n_post_mix = (const float*)d_in[5]; const float* n_pre_ffn = (const float*)d_in[6]; const float* n_post_ffn = (const float*)d_in[7];
    const float* w_in = (const float*)d_in[8]; const float* b_in = (const float*)d_in[9]; const float* conv_w = (const float*)d_in[10]; const float* conv_b = (const float*)d_in[11];
    const float* rg_w_a = (const float*)d_in[12]; const float* rg_b_a = (const float*)d_in[13]; const float* rg_w_x = (const float*)d_in[14]; const float* rg_b_x = (const float*)d_in[15];
    const float* rg_lambda = (const float*)d_in[16]; const float* sinks = (const float*)d_in[17]; const float* w_o_rnn = (const float*)d_in[18]; const float* w_o_attn = (const float*)d_in[19];
    const float* w_out = (const float*)d_in[20]; const float* router_w = (const float*)d_in[21]; const float* router_b = (const float*)d_in[22];
    const float* moe_w1 = (const float*)d_in[23]; const float* moe_b1 = (const float*)d_in[24]; const float* moe_w2 = (const float*)d_in[25]; const float* moe_b2 = (const float*)d_in[26];
    float* out = (float*)d_out; char* ws = (char*)d_ws;
    if (n_in != 27 || ws_size < WS_NEED) { (void)hipMemsetAsync(d_out, 0, (size_t)out_size * 4, stream); return; }
    float* ADA = (float*)(ws + OFF_ADA); int* CNT = (int*)(ws + OFF_CNT); float* GATES = (float*)(ws + OFF_GATES); int* EIDX = (int*)(ws + OFF_EIDX); int* LIST = (int*)(ws + OFF_LIST);
    float* XR = (float*)(ws + WS_XR); float* GR = (float*)(ws + WS_GR); float* Q = (float*)(ws + WS_Q); float* K = (float*)(ws + WS_K); float* V = (float*)(ws + WS_V);
    float* GTR = (float*)(ws + WS_GTR); float* GTA = (float*)(ws + WS_GTA);
    float* H = (float*)(ws + WS_H); float* YATT = (float*)(ws + WS_YATT);
    float* T1 = (float*)(ws + WS_T1); float* T2 = (float*)(ws + WS_T2); float* MG = (float*)(ws + WS_MERGED);
    float* MIX = (float*)(ws + WS_MIX); float* X1 = (float*)(ws + WS_X1); float* H2 = (float*)(ws + WS_H2); float* ACT = (float*)(ws + WS_ACT); float* FF = (float*)(ws + WS_FF);

    k_ada<<<2 * 6144 / 256, 256, 0, stream>>>(c, w_ada, b_ada, ADA);
    k_rmsmod<<<NTOK / 4, 256, 0, stream>>>(x, n_pre_mix, ADA, 0, 1024, H);
    auto proj = [&](int c0, int n, float* dst) { GemmArgs g = mk_gemm(H, DM, nullptr, 0, 0, nullptr, w_in + c0, DIN, 0, NTOK, n, DM);
        k_gemm<EpiStore><<<dim3(n / 64, NTOK / 64, 1), 256, 0, stream>>>(g, EpiStore{dst, b_in + c0, n, 0}); };
    proj(C_XR, 1024, XR); proj(C_GR, 1024, GR); proj(C_Q, 1024, Q); proj(C_K, 256, K); proj(C_V, 256, V); proj(C_GTR, 1024, GTR); proj(C_GTA, 1024, GTA);
    float* XC = H; float* LOGA = XR; float* BT = YATT; float* YR = H;
    k_conv<<<NTOK * DM / 256, 256, 0, stream>>>(XR, conv_w, conv_b, XC);
    k_gates<<<NTOK * DM / 256, 256, 0, stream>>>(XC, rg_w_a, rg_b_a, rg_w_x, rg_b_x, rg_lambda, LOGA, BT);
    k_scan<<<BATCH * DM / 64, 64, 0, stream>>>(LOGA, BT, GR, YR);
    k_attn<<<NTOK * NH / 4, 256, 0, stream>>>(Q, K, V, sinks, YATT);
    { GemmArgs g = mk_gemm(YR, DM, nullptr, 0, 0, nullptr, w_o_rnn, DM, 0, NTOK, DM, DM); k_gemm<EpiStore><<<dim3(DM / 64, NTOK / 64, 1), 256, 0, stream>>>(g, EpiStore{T1, nullptr, DM, 0}); }
    { GemmArgs g = mk_gemm(YATT, DM, nullptr, 0, 0, nullptr, w_o_attn, DM, 0, NTOK, DM, DM); k_gemm<EpiStore><<<dim3(DM / 64, NTOK / 64, 1), 256, 0, stream>>>(g, EpiStore{T2, nullptr, DM, 0}); }
    k_merge<<<NTOK * DM / 256, 256, 0, stream>>>(GTR, GTA, T1, T2, MG);
    { GemmArgs g = mk_gemm(MG, DM, nullptr, 0, 0, nullptr, w_out, DM, 0, NTOK, DM, DM); k_gemm<EpiStore><<<dim3(DM / 64, NTOK / 64, 1), 256, 0, stream>>>(g, EpiStore{MIX, nullptr, DM, 0}); }
    k_resnorm<<<NTOK / 4, 256, 0, stream>>>(x, MIX, n_post_mix, ADA, 2048, X1);
    k_rmsmod<<<NTOK / 4, 256, 0, stream>>>(X1, n_pre_ffn, ADA, 3072, 4096, H2);
    k_router<<<NTOK / 64, 64, 0, stream>>>(H2, router_w, router_b, GATES, EIDX);
    k_lists<<<1, 64, 0, stream>>>(EIDX, LIST, CNT);
    (void)hipMemsetAsync(FF, 0, (size_t)NTOK * DM * 4, stream);
    { GemmArgs g = mk_gemm(H2, DM, LIST, 2, NTOK, CNT, moe_w1, 2 * DFF, (size_t)DM * 2 * DFF, 0, 2 * DFF, DM);
      k_gemm<EpiSwiglu><<<dim3(2 * DFF / 64, NTOK / 64, NE), 256, 0, stream>>>(g, EpiSwiglu{ACT, moe_b1}); }
    { GemmArgs g = mk_gemm(ACT, DFF, LIST, 0, NTOK, CNT, moe_w2, DM, (size_t)DFF * DM, 0, DM, DFF);
      k_gemm<EpiMoeOut><<<dim3(DM / 64, NTOK / 64, NE), 256, 0, stream>>>(g, EpiMoeOut{FF, moe_b2, GATES}); }
    k_resnorm<<<NTOK / 4, 256, 0, stream>>>(X1, FF, n_post_ffn, ADA, 5120, out);
}
```
